# Optimizing an MI355X kernel written in HIP

```python
import math
import jax, jax.numpy as jnp
from jax import lax
import numpy as np

D_MODEL = 1024
BATCH = 8
SEQ = 4096
DEPTH = 1

POOL_WINDOWS = (2, 4, 8, 16)
POOL_GROUPS = len(POOL_WINDOWS)
POOL_WIDTH = D_MODEL // 2
POOL_GROUP_DIM = POOL_WIDTH // POOL_GROUPS
RNN_WIDTH = D_MODEL
RNN_HEADS = 16
RNN_HEAD_DIM = RNN_WIDTH // RNN_HEADS
RNN_CONV = 4
LRU_C = 8.0
D_FF = 3 * D_MODEL
FFN_CONV = 3
PLE_DIM = 256
N_BRANCH = 2
RMS_EPS = 1e-6
IN_POOL = POOL_WIDTH
IN_RNN_X = RNN_WIDTH
IN_RNN_G = RNN_WIDTH
IN_GATES = N_BRANCH * D_MODEL
IN_TOTAL = IN_POOL + IN_RNN_X + IN_RNN_G + IN_GATES

kernel_name = "hybrid_pool_rglru_gated_block"


def rms_norm(x, g):
    xf = x.astype(jnp.float32)
    y = xf * lax.rsqrt(jnp.mean(xf * xf, axis=-1, keepdims=True) + RMS_EPS) * g.astype(jnp.float32)
    return y.astype(x.dtype)


def causal_dwconv(u, w, b):
    k_w = w.shape[0]
    s = u.shape[1]
    up = jnp.pad(u, ((0, 0), (k_w - 1, 0), (0, 0)))
    out = b + up[:, 0:s] * w[0]
    for k in range(1, k_w):
        out = out + up[:, k:k + s] * w[k]
    return out


def pool_mixer(u, pool_w, pool_scale):
    b, s, _ = u.shape
    uf = u.astype(jnp.float32)
    cs = jnp.pad(jnp.cumsum(uf, axis=1), ((0, 0), (1, 0), (0, 0)))
    t = jnp.arange(s, dtype=jnp.int32)
    outs = []
    for g, w in enumerate(POOL_WINDOWS):
        sl = cs[..., g * POOL_GROUP_DIM:(g + 1) * POOL_GROUP_DIM]
        prev = jnp.pad(sl, ((0, 0), (w - 1, 0), (0, 0)))[:, :s]
        count = jnp.minimum(t + 1, w).astype(jnp.float32)[None, :, None]
        outs.append((sl[:, 1:] - prev) / count)
    mean = jnp.concatenate(outs, axis=-1)
    d = (mean - uf).astype(u.dtype).reshape(b, s, POOL_GROUPS, POOL_GROUP_DIM)
    y = jnp.einsum('bsgc,gcd->bsgd', d, pool_w).reshape(b, s, POOL_WIDTH)
    return y * pool_scale


def rg_lru_branch(xb, gb, conv_w, conv_b, w_gates, b_gates, lru_lambda):
    b, s, _ = xb.shape
    xc = causal_dwconv(xb, conv_w, conv_b)
    xh = xc.reshape(b, s, RNN_HEADS, RNN_HEAD_DIM)
    gates = jnp.einsum('bshi,ghij->gbshj', xh, w_gates).reshape(2, b, s, RNN_WIDTH)
    gates = gates.astype(jnp.float32) + b_gates.astype(jnp.float32)[:, None, None, :]
    r = jax.nn.sigmoid(gates[0])
    i = jax.nn.sigmoid(gates[1])
    log_a = -LRU_C * r * jax.nn.softplus(-lru_lambda.astype(jnp.float32))
    a = jnp.exp(log_a)
    mult = jnp.sqrt(-jnp.expm1(2.0 * log_a))
    t0 = (jnp.arange(s) == 0)[None, :, None]
    mult = jnp.where(t0, 1.0, mult)
    u = mult * i * xc.astype(jnp.float32)

    def combine(left, right):
        a_l, h_l = left
        a_r, h_r = right
        return a_l * a_r, a_r * h_l + h_r

    _, h = lax.associative_scan(combine, (a, u), axis=1)
    return h.astype(xb.dtype) * jax.nn.gelu(gb)


def setup_inputs(seed: int = 0) -> dict:
    key = jax.random.key(seed)
    ks = jax.random.split(key, 32)
    f32 = jnp.float32
    L = DEPTH

    def nrm(k, shape, fan_in):
        return jax.random.normal(k, shape, f32) * (fan_in ** -0.5)

    def gain(k, shape):
        return 1.0 + 0.05 * jax.random.normal(k, shape, f32)

    a_c = jax.random.uniform(ks[10], (L, RNN_WIDTH), f32, 0.9, 0.999)
    s_l = a_c ** (1.0 / LRU_C)
    lru_lambda = jnp.log(s_l) - jnp.log1p(-s_l)

    return {
        "x": jax.random.normal(ks[0], (BATCH, SEQ, D_MODEL), f32),
        "p": jax.random.normal(ks[1], (DEPTH, BATCH, SEQ, PLE_DIM), f32),
        "g_mix_pre": gain(ks[2], (L, D_MODEL)),
        "g_mix_post": gain(ks[3], (L, D_MODEL)),
        "w_in": nrm(ks[4], (L, D_MODEL, IN_TOTAL), D_MODEL),
        "pool_w": nrm(ks[5], (L, POOL_GROUPS, POOL_GROUP_DIM, POOL_GROUP_DIM), POOL_GROUP_DIM),
        "pool_scale": gain(ks[6], (L, POOL_WIDTH)),
        "w_pool_out": nrm(ks[7], (L, POOL_WIDTH, D_MODEL), POOL_WIDTH),
        "conv_w": nrm(ks[8], (L, RNN_CONV, RNN_WIDTH), RNN_CONV),
        "conv_b": 0.02 * jax.random.normal(ks[9], (L, RNN_WIDTH), f32),
        "w_rg_gates": nrm(ks[11], (L, 2, RNN_HEADS, RNN_HEAD_DIM, RNN_HEAD_DIM), RNN_HEAD_DIM),
        "b_rg_gates": 0.02 * jax.random.normal(ks[12], (L, 2, RNN_WIDTH), f32),
        "lru_lambda": lru_lambda,
        "w_rg_out": nrm(ks[13], (L, RNN_WIDTH, D_MODEL), RNN_WIDTH),
        "w_o": nrm(ks[14], (L, D_MODEL, D_MODEL), D_MODEL),
        "g_ffn_pre": gain(ks[15], (L, D_MODEL)),
        "g_ffn_post": gain(ks[16], (L, D_MODEL)),
        "w_up": nrm(ks[17], (L, D_MODEL, 2 * D_FF), D_MODEL),
        "ffn_conv_w": nrm(ks[18], (L, FFN_CONV, D_FF), FFN_CONV),
        "ffn_conv_b": 0.02 * jax.random.normal(ks[19], (L, D_FF), f32),
        "w_down": nrm(ks[20], (L, D_FF, D_MODEL), D_FF),
        "g_ple_gate": gain(ks[21], (L, D_MODEL)),
        "w_ple_gate": nrm(ks[22], (L, D_MODEL, D_MODEL), D_MODEL),
        "w_ple_proj": nrm(ks[23], (L, PLE_DIM, D_MODEL), PLE_DIM),
        "g_ple_post": gain(ks[24], (L, D_MODEL)),
    }


def reference(x, p, g_mix_pre, g_mix_post, w_in, pool_w, pool_scale, w_pool_out,
              conv_w, conv_b, w_rg_gates, b_rg_gates, lru_lambda, w_rg_out, w_o,
              g_ffn_pre, g_ffn_post, w_up, ffn_conv_w, ffn_conv_b, w_down,
              g_ple_gate, w_ple_gate, w_ple_proj, g_ple_post):
    for l in range(DEPTH):
        h = rms_norm(x, g_mix_pre[l])
        z = h @ w_in[l]
        c0 = IN_POOL
        c1 = c0 + IN_RNN_X
        c2 = c1 + IN_RNN_G
        u_pool = z[..., :c0]
        u_rx = z[..., c0:c1]
        u_rg = z[..., c1:c2]
        gate_pool = jax.nn.sigmoid(z[..., c2:c2 + D_MODEL])
        gate_rnn = jax.nn.sigmoid(z[..., c2 + D_MODEL:])

        y_pool = pool_mixer(u_pool, pool_w[l], pool_scale[l]) @ w_pool_out[l]
        y_rnn = rg_lru_branch(u_rx, u_rg, conv_w[l], conv_b[l], w_rg_gates[l],
                              b_rg_gates[l], lru_lambda[l]) @ w_rg_out[l]
        merged = gate_pool * y_pool + gate_rnn * y_rnn
        x = x + rms_norm(merged @ w_o[l], g_mix_post[l])

        h = rms_norm(x, g_ffn_pre[l])
        up = h @ w_up[l]
        gate_h = causal_dwconv(up[..., :D_FF], ffn_conv_w[l], ffn_conv_b[l])
        hid = jax.nn.gelu(gate_h) * up[..., D_FF:]
        x = x + rms_norm(hid @ w_down[l], g_ffn_post[l])

        ple_gate = jax.nn.sigmoid(rms_norm(x, g_ple_gate[l]) @ w_ple_gate[l])
        ple = rms_norm(p[l].astype(x.dtype) @ w_ple_proj[l], g_ple_post[l])
        x = x + ple_gate * ple
    return x
```

```cpp
#include <hip/hip_runtime.h>
#include <cstdio>
#include <cstdint>

namespace nv {
constexpr int D = 1024, S = 4096, NB = 8, NIN = 4608, FF = 3072, PLE = 256;
constexpr float EPS = 1e-6f;

__device__ __forceinline__ float sigmoidf_(float x) { return 1.f / (1.f + __expf(-x)); }
__device__ __forceinline__ float gelu_tanh(float x) { const float u = 0.7978845608028654f * (x + 0.044715f * x * x * x); return 0.5f * x * (1.f + tanhf(u)); }

__global__ void __launch_bounds__(256) k_gemm(const float* __restrict__ A, int lda, const float* __restrict__ W, int ldw, float* __restrict__ C, int ldc, int m, int N, int K) {
    __shared__ float As[16][64 + 1], Ws[16][64 + 1];
    const int tx = threadIdx.x & 15, ty = threadIdx.x >> 4, r0 = blockIdx.y * 64, c0 = blockIdx.x * 64;
    float acc[4][4] = {};
    for (int k0 = 0; k0 < K; k0 += 16) {
        for (int i = threadIdx.x; i < 64 * 16; i += 256) { const int r = i >> 4, k = i & 15; As[k][r] = A[(size_t)(r0 + r) * lda + k0 + k]; }
        for (int i = threadIdx.x; i < 64 * 16; i += 256) { const int k = i >> 6, c = i & 63; Ws[k][c] = W[(size_t)(k0 + k) * ldw + c0 + c]; }
        __syncthreads();
#pragma unroll
        for (int k = 0; k < 16; ++k) { float a[4], b[4];
#pragma unroll
            for (int i = 0; i < 4; ++i) { a[i] = As[k][ty * 4 + i]; b[i] = Ws[k][tx * 4 + i]; }
#pragma unroll
            for (int i = 0; i < 4; ++i)
#pragma unroll
                for (int j = 0; j < 4; ++j) acc[i][j] += a[i] * b[j]; }
        __syncthreads();
    }
#pragma unroll
    for (int i = 0; i < 4; ++i)
#pragma unroll
        for (int j = 0; j < 4; ++j) C[(size_t)(r0 + ty * 4 + i) * ldc + c0 + tx * 4 + j] = acc[i][j];
}
__global__ void __launch_bounds__(256) k_rms(const float* __restrict__ in, const float* __restrict__ g, const float* base, float* out) {
    __shared__ float red[4];
    const size_t row = blockIdx.x; const float4 v = ((const float4*)(in + row * D))[threadIdx.x];
    float s = v.x * v.x + v.y * v.y + v.z * v.z + v.w * v.w;
    for (int o = 32; o > 0; o >>= 1) s += __shfl_xor(s, o);
    if ((threadIdx.x & 63) == 0) red[threadIdx.x >> 6] = s;
    __syncthreads();
    const float rstd = rsqrtf((red[0] + red[1] + red[2] + red[3]) * (1.f / D) + EPS);
    const float4 gg = ((const float4*)g)[threadIdx.x]; float4 b = {0.f, 0.f, 0.f, 0.f}; if (base) b = ((const float4*)(base + row * D))[threadIdx.x];
    float4 o; o.x = b.x + v.x * rstd * gg.x; o.y = b.y + v.y * rstd * gg.y; o.z = b.z + v.z * rstd * gg.z; o.w = b.w + v.w * rstd * gg.w;
    ((float4*)(out + row * D))[threadIdx.x] = o;
}
__global__ void k_pool_d(const float* __restrict__ Z, float* __restrict__ Dd) {
    const int i = blockIdx.x * blockDim.x + threadIdx.x; if (i >= S * 512) return;
    const int t = i / 512, c = i % 512, g = c / 128, w = 2 << g;
    float s = 0.f; for (int j = 0; j < w; ++j) if (t - j >= 0) s += Z[(size_t)(t - j) * NIN + c];
    const int cnt = (t + 1 < w) ? t + 1 : w;
    Dd[(size_t)t * 1024 + c] = s / (float)cnt - Z[(size_t)t * NIN + c];
}
__global__ void k_pool_w(const float* Dd, const float* __restrict__ pw, const float* __restrict__ sc, float* Y1) {
    const int i = blockIdx.x * blockDim.x + threadIdx.x; if (i >= S * 512) return;
    const int t = i / 512, n = i % 512, g = n / 128, dd = n % 128;
    float s = 0.f; for (int c = 0; c < 128; ++c) s += Dd[(size_t)t * 1024 + g * 128 + c] * pw[(size_t)(g * 128 + c) * 128 + dd];
    Y1[(size_t)t * 1024 + 512 + n] = s * sc[n];
}
__global__ void k_rnn_conv(const float* __restrict__ Z, const float* __restrict__ cw, const float* __restrict__ cb, float* __restrict__ XC) {
    const int i = blockIdx.x * blockDim.x + threadIdx.x; if (i >= S * 1024) return;
    const int t = i / 1024, c = i % 1024; float s = cb[c];
    for (int k = 0; k < 4; ++k) { const int tt = t - 3 + k; if (tt >= 0) s += Z[(size_t)tt * NIN + 512 + c] * cw[k * 1024 + c]; }
    XC[(size_t)t * 3072 + c] = s;
}
__global__ void k_rnn_gate(const float* __restrict__ XC, const float* __restrict__ wg, const float* __restrict__ bg, const float* __restrict__ lam, float* __restrict__ Aa, float* __restrict__ Uu) {
    const int i = blockIdx.x * blockDim.x + threadIdx.x; if (i >= S * 1024) return;
    const int t = i / 1024, c = i % 1024, h = c / 64, j = c % 64;
    float gr = bg[c], gi = bg[1024 + c];
    for (int k = 0; k < 64; ++k) { const float x = XC[(size_t)t * 3072 + h * 64 + k]; gr += x * wg[((size_t)(0 * 16 + h) * 64 + k) * 64 + j]; gi += x * wg[((size_t)(1 * 16 + h) * 64 + k) * 64 + j]; }
    const float r = sigmoidf_(gr), ii = sigmoidf_(gi);
    const float L = lam[c], sp = (L < -20.f) ? -L : log1pf(expf(-L));
    const float log_a = -8.0f * r * sp, a = expf(log_a); float mult = sqrtf(-expm1f(2.f * log_a)); if (t == 0) mult = 1.f;
    Aa[(size_t)t * 1024 + c] = a; Uu[(size_t)t * 1024 + c] = mult * ii * XC[(size_t)t * 3072 + c];
}
__global__ void k_rnn_scan(const float* __restrict__ Aa, const float* __restrict__ Uu, const float* __restrict__ Z, float* __restrict__ H) {
    const int c = blockIdx.x * blockDim.x + threadIdx.x; if (c >= 1024) return;
    float h = 0.f;
    for (int t = 0; t < S; ++t) { h = Aa[(size_t)t * 1024 + c] * h + Uu[(size_t)t * 1024 + c]; H[(size_t)t * 1024 + c] = h * gelu_tanh(Z[(size_t)t * NIN + 1536 + c]); }
}
__global__ void k_merge(const float* __restrict__ Z, const float* __restrict__ YP, const float* __restrict__ YR, float* __restrict__ MG) {
    const int i = blockIdx.x * blockDim.x + threadIdx.x; if (i >= S * 1024) return;
    const int t = i / 1024, c = i % 1024;
    MG[i] = sigmoidf_(Z[(size_t)t * NIN + 2560 + c]) * YP[i] + sigmoidf_(Z[(size_t)t * NIN + 3584 + c]) * YR[i];
}
__global__ void k_ffn_act(const float* __restrict__ UP, const float* __restrict__ cw, const float* __restrict__ cb, float* __restrict__ HID) {
    const int i = blockIdx.x * blockDim.x + threadIdx.x; if (i >= S * FF) return;
    const int t = i / FF, c = i % FF; float s = cb[c];
    for (int k = 0; k < 3; ++k) { const int tt = t - 2 + k; if (tt >= 0) s += UP[(size_t)tt * 6144 + c] * cw[k * FF + c]; }
    HID[i] = gelu_tanh(s) * UP[(size_t)t * 6144 + FF + c];
}
__global__ void k_final(const float* __restrict__ X2, const float* __restrict__ PG, const float* __restrict__ PLn, float* __restrict__ out) {
    const int i = blockIdx.x * blockDim.x + threadIdx.x; if (i >= S * 1024) return;
    out[i] = X2[i] + sigmoidf_(PG[i]) * PLn[i];
}
}

extern "C" void kernel_launch(void* const* d_in, const int* in_sizes, int n_in, void* d_out, int out_size, void* d_ws, size_t ws_size, hipStream_t stream) {
    using namespace nv;
    const float* x = (const float*)d_in[0]; const float* p = (const float*)d_in[1];
    const float *g_mix_pre = (const float*)d_in[2], *g_mix_post = (const float*)d_in[3], *w_in = (const float*)d_in[4], *pool_w = (const float*)d_in[5], *pool_scale = (const float*)d_in[6],
                *w_pool_out = (const float*)d_in[7], *conv_w = (const float*)d_in[8], *conv_b = (const float*)d_in[9], *w_rg_gates = (const float*)d_in[10], *b_rg_gates = (const float*)d_in[11],
                *lru_lambda = (const float*)d_in[12], *w_rg_out = (const float*)d_in[13], *w_o = (const float*)d_in[14], *g_ffn_pre = (const float*)d_in[15], *g_ffn_post = (const float*)d_in[16],
                *w_up = (const float*)d_in[17], *ffn_conv_w = (const float*)d_in[18], *ffn_conv_b = (const float*)d_in[19], *w_down = (const float*)d_in[20], *g_ple_gate = (const float*)d_in[21],
                *w_ple_gate = (const float*)d_in[22], *w_ple_proj = (const float*)d_in[23], *g_ple_post = (const float*)d_in[24];
    float* out = (float*)d_out; float* ws = (float*)d_ws;
    float* R0 = ws;
    float* R1 = R0 + (size_t)S * 6144;
    float* R2 = R1 + (size_t)S * 3072;
    float* R3 = R2 + (size_t)S * 1024;
    float* R4 = R3 + (size_t)S * 1024;
    float* R5 = R4 + (size_t)S * 1024;
    float* R6 = R5 + (size_t)S * 1024;
    float* R7 = R6 + (size_t)S * 1024;
    float* R8 = R7 + (size_t)S * 1024;
    float* R9 = R8 + (size_t)S * 1024;
    const int EB = 256;
    auto gemm = [&](const float* A, int lda, const float* W, int ldw, float* C, int ldc, int N, int K) { hipLaunchKernelGGL(k_gemm, dim3(N / 64, S / 64), dim3(256), 0, stream, A, lda, W, ldw, C, ldc, S, N, K); };
    for (int b = 0; b < NB; ++b) {
        const float* xb = x + (size_t)b * S * D; const float* pb = p + (size_t)b * S * PLE; float* ob = out + (size_t)b * S * D;
        hipLaunchKernelGGL(k_rms, dim3(S), dim3(256), 0, stream, xb, g_mix_pre, (const float*)nullptr, R2);
        gemm(R2, D, w_in, NIN, R0, NIN, NIN, D);
        hipLaunchKernelGGL(k_pool_d, dim3(S * 512 / EB), dim3(EB), 0, stream, R0, R3);
        hipLaunchKernelGGL(k_pool_w, dim3(S * 512 / EB), dim3(EB), 0, stream, R3, pool_w, pool_scale, R3);
        gemm(R3 + 512, 1024, w_pool_out, D, R7, D, D, 512);
        hipLaunchKernelGGL(k_rnn_conv, dim3(S * 1024 / EB), dim3(EB), 0, stream, R0, conv_w, conv_b, R1);
        hipLaunchKernelGGL(k_rnn_gate, dim3(S * 1024 / EB), dim3(EB), 0, stream, R1, w_rg_gates, b_rg_gates, lru_lambda, R4, R5);
        hipLaunchKernelGGL(k_rnn_scan, dim3(1024 / 64), dim3(64), 0, stream, R4, R5, R0, R6);
        gemm(R6, D, w_rg_out, D, R8, D, D, D);
        hipLaunchKernelGGL(k_merge, dim3(S * 1024 / EB), dim3(EB), 0, stream, R0, R7, R8, R4);
        gemm(R4, D, w_o, D, R5, D, D, D);
        hipLaunchKernelGGL(k_rms, dim3(S), dim3(256), 0, stream, R5, g_mix_post, xb, R9);
        hipLaunchKernelGGL(k_rms, dim3(S), dim3(256), 0, stream, R9, g_ffn_pre, (const float*)nullptr, R2);
        gemm(R2, D, w_up, 2 * FF, R0, 2 * FF, 2 * FF, D);
        hipLaunchKernelGGL(k_ffn_act, dim3(S * FF / EB), dim3(EB), 0, stream, R0, ffn_conv_w, ffn_conv_b, R1);
        gemm(R1, FF, w_down, D, R3, D, D, FF);
        hipLaunchKernelGGL(k_rms, dim3(S), dim3(256), 0, stream, R3, g_ffn_post, R9, R9);
        hipLaunchKernelGGL(k_rms, dim3(S), dim3(256), 0, stream, R9, g_ple_gate, (const float*)nullptr, R2);
        gemm(R2, D, w_ple_gate, D, R3, D, D, D);
        gemm(pb, PLE, w_ple_proj, D, R4, D, D, PLE);
        hipLaunchKernelGGL(k_rms, dim3(S), dim3(256), 0, stream, R4, g_ple_post, (const float*)nullptr, R5);
        hipLaunchKernelGGL(k_final, dim3(S * 1024 / EB), dim3(EB), 0, stream, R9, R3, R5, ob);
    }
}
```
